# Optimizing an MI355X kernel written in HIP

```python
import math
import jax, jax.numpy as jnp
from jax import lax
import numpy as np

D_MODEL = 1024
BATCH = 8
SEQ = 4096
DEPTH = 4

N_MIXERS = 2
N_SSD_LAYERS = (DEPTH + N_MIXERS - 1) // N_MIXERS
N_LRU_LAYERS = DEPTH // N_MIXERS
SSD_EXPAND = 2
SSD_D_INNER = SSD_EXPAND * D_MODEL
SSD_HEADDIM = 64
SSD_HEADS = SSD_D_INNER // SSD_HEADDIM
SSD_GROUPS = 4
SSD_HPG = SSD_HEADS // SSD_GROUPS
SSD_D_STATE = 128
SSD_CONV = 4
SSD_CHUNK = 128
SSD_CONV_DIM = SSD_D_INNER + 2 * SSD_GROUPS * SSD_D_STATE
SSD_IN_DIM = SSD_D_INNER + SSD_CONV_DIM + SSD_HEADS
LRU_WIDTH = 1280
LRU_HEADS = 10
LRU_BLOCK = LRU_WIDTH // LRU_HEADS
LRU_CONV = 4
LRU_C = 8.0
D_FF = 4 * D_MODEL
FFN_CONV = 3
EPS = 1e-6

kernel_name = 'hybrid_ssd_rglru_convffn_trunk'


def rmsnorm(x, w):
    xf = x.astype(jnp.float32)
    y = xf * lax.rsqrt(jnp.mean(xf * xf, axis=-1, keepdims=True) + EPS)
    return (y * w.astype(jnp.float32)).astype(x.dtype)


def causal_dwconv(x, w, b):
    k = w.shape[0]
    s = x.shape[1]
    xp = jnp.pad(x, ((0, 0), (k - 1, 0), (0, 0)))
    y = b
    for j in range(k):
        y = y + xp[:, j:j + s, :] * w[j]
    return y


def ssd_chunked_scan(xh, dt, a, bm, cm):
    bsz, s, h, p = xh.shape
    nc = s // SSD_CHUNK
    xdt = (xh * dt[..., None]).reshape(bsz, nc, SSD_CHUNK, SSD_GROUPS, SSD_HPG, p)
    da = (dt * a).reshape(bsz, nc, SSD_CHUNK, SSD_GROUPS, SSD_HPG)
    bc = bm.reshape(bsz, nc, SSD_CHUNK, SSD_GROUPS, SSD_D_STATE)
    cc = cm.reshape(bsz, nc, SSD_CHUNK, SSD_GROUPS, SSD_D_STATE)
    cs = jnp.moveaxis(jnp.cumsum(da, axis=2), 2, -1)
    tri = jnp.tril(jnp.ones((SSD_CHUNK, SSD_CHUNK), dtype=bool))
    decay_in = jnp.exp(jnp.where(tri, cs[..., :, None] - cs[..., None, :], -jnp.inf))
    cb = jnp.einsum('bclgn,bcsgn->bcgls', cc, bc)
    scores = cb[:, :, :, None] * decay_in
    y_diag = jnp.einsum('bcgels,bcsgep->bclgep', scores, xdt)
    decay_out = jnp.moveaxis(jnp.exp(cs[..., -1:] - cs), -1, 2)
    states = jnp.einsum('bclgn,bclgep->bcgepn', bc, xdt * decay_out[..., None])
    tot = cs[..., -1]
    inc = jnp.moveaxis(jnp.cumsum(tot, axis=1), 1, -1)
    exc = inc - jnp.moveaxis(tot, 1, -1)
    stri = jnp.tril(jnp.ones((nc, nc), dtype=bool), -1)
    decay_chunk = jnp.exp(jnp.where(stri, exc[..., :, None] - inc[..., None, :], -jnp.inf))
    entering = jnp.einsum('bgezc,bcgepn->bzgepn', decay_chunk, states)
    state_decay = jnp.moveaxis(jnp.exp(cs), -1, 2)
    y_off = jnp.einsum('bclgn,bcgepn->bclgep', cc, entering) * state_decay[..., None]
    return (y_diag + y_off).reshape(bsz, s, h, p)


def gated_group_rmsnorm(y, z, w):
    bsz, s, d = y.shape
    g = (y * jax.nn.silu(z.astype(jnp.float32))).reshape(bsz, s, SSD_GROUPS, d // SSD_GROUPS)
    g = g * lax.rsqrt(jnp.mean(g * g, axis=-1, keepdims=True) + EPS)
    return g.reshape(bsz, s, d) * w.astype(jnp.float32)


def ssd_mixer(u, w_in, conv_w, conv_b, dt_bias, a_log, d_skip, norm_w, w_out):
    bsz, s, _ = u.shape
    proj = u @ w_in
    z = proj[..., :SSD_D_INNER]
    xbc = proj[..., SSD_D_INNER:SSD_D_INNER + SSD_CONV_DIM]
    dt_raw = proj[..., SSD_D_INNER + SSD_CONV_DIM:]
    xbc = jax.nn.silu(causal_dwconv(xbc, conv_w, conv_b)).astype(jnp.float32)
    xs = xbc[..., :SSD_D_INNER].reshape(bsz, s, SSD_HEADS, SSD_HEADDIM)
    bm = xbc[..., SSD_D_INNER:SSD_D_INNER + SSD_GROUPS * SSD_D_STATE].reshape(bsz, s, SSD_GROUPS, SSD_D_STATE)
    cm = xbc[..., SSD_D_INNER + SSD_GROUPS * SSD_D_STATE:].reshape(bsz, s, SSD_GROUPS, SSD_D_STATE)
    dt = jax.nn.softplus(dt_raw.astype(jnp.float32) + dt_bias.astype(jnp.float32))
    a = -jnp.exp(a_log.astype(jnp.float32))
    y = ssd_chunked_scan(xs, dt, a, bm, cm)
    y = y + d_skip.astype(jnp.float32)[:, None] * xs
    y = gated_group_rmsnorm(y.reshape(bsz, s, SSD_D_INNER), z, norm_w)
    return (y.astype(u.dtype) @ w_out).astype(u.dtype)


def _linear_combine(c1, c2):
    a1, b1 = c1
    a2, b2 = c2
    return a1 * a2, a2 * b1 + b2


def rglru_mixer(u, w_in, b_in, conv_w, conv_b, w_gx, b_gx, w_ga, b_ga, lam, w_out, b_out):
    bsz, s, _ = u.shape
    proj = u @ w_in + b_in
    ybr = jax.nn.gelu(proj[..., :LRU_WIDTH].astype(jnp.float32))
    xbr = causal_dwconv(proj[..., LRU_WIDTH:], conv_w, conv_b)
    xh = xbr.reshape(bsz, s, LRU_HEADS, LRU_BLOCK)
    gx = jax.nn.sigmoid((jnp.einsum('bshi,hij->bshj', xh, w_gx).reshape(bsz, s, LRU_WIDTH) + b_gx).astype(jnp.float32))
    ga = jax.nn.sigmoid((jnp.einsum('bshi,hij->bshj', xh, w_ga).reshape(bsz, s, LRU_WIDTH) + b_ga).astype(jnp.float32))
    log_a = LRU_C * ga * jax.nn.log_sigmoid(lam.astype(jnp.float32))
    a_t = jnp.exp(log_a)
    mult = jnp.sqrt(-jnp.expm1(2.0 * log_a))
    b_t = mult * gx * xbr.astype(jnp.float32)
    _, h = lax.associative_scan(_linear_combine, (a_t, b_t), axis=1)
    out = (h * ybr).astype(u.dtype) @ w_out + b_out
    return out.astype(u.dtype)


def conv_ffn(u, w_up, conv_w, conv_b, w_down):
    hcv = causal_dwconv(u @ w_up, conv_w, conv_b)
    g = hcv[..., :D_FF]
    v = hcv[..., D_FF:]
    return ((jax.nn.gelu(g.astype(jnp.float32)) * v.astype(jnp.float32)).astype(u.dtype) @ w_down).astype(u.dtype)


def setup_inputs(seed: int = 0) -> dict:
    key = jax.random.key(seed)
    ks = jax.random.split(key, 32)
    f32 = jnp.float32

    def nrm(k, shape, scale):
        return scale * jax.random.normal(k, shape, f32)

    def gain(k, shape):
        return 1.0 + 0.1 * jax.random.normal(k, shape, f32)

    na, nb = N_SSD_LAYERS, N_LRU_LAYERS
    dt0 = jnp.exp(jax.random.uniform(ks[9], (na, SSD_HEADS), f32, math.log(1e-3), math.log(1e-1)))
    lam_u = jax.random.uniform(ks[20], (nb, LRU_WIDTH), f32, 0.9, 0.999)
    return {
        'x': jax.random.normal(ks[0], (BATCH, SEQ, D_MODEL), f32),
        'norm_mix_pre': gain(ks[1], (DEPTH, D_MODEL)),
        'norm_mix_post': gain(ks[2], (DEPTH, D_MODEL)),
        'norm_ffn_pre': gain(ks[3], (DEPTH, D_MODEL)),
        'norm_ffn_post': gain(ks[4], (DEPTH, D_MODEL)),
        'ssd_w_in': nrm(ks[5], (na, D_MODEL, SSD_IN_DIM), D_MODEL ** -0.5),
        'ssd_conv_w': nrm(ks[6], (na, SSD_CONV, SSD_CONV_DIM), SSD_CONV ** -0.5),
        'ssd_conv_b': nrm(ks[7], (na, SSD_CONV_DIM), 0.01),
        'ssd_dt_bias': dt0 + jnp.log(-jnp.expm1(-dt0)),
        'ssd_a_log': jnp.log(jax.random.uniform(ks[10], (na, SSD_HEADS), f32, 1.0, 16.0)),
        'ssd_d': gain(ks[11], (na, SSD_HEADS)),
        'ssd_norm': gain(ks[12], (na, SSD_D_INNER)),
        'ssd_w_out': nrm(ks[13], (na, SSD_D_INNER, D_MODEL), SSD_D_INNER ** -0.5),
        'lru_w_in': nrm(ks[14], (nb, D_MODEL, 2 * LRU_WIDTH), D_MODEL ** -0.5),
        'lru_b_in': nrm(ks[15], (nb, 2 * LRU_WIDTH), 0.01),
        'lru_conv_w': nrm(ks[16], (nb, LRU_CONV, LRU_WIDTH), LRU_CONV ** -0.5),
        'lru_conv_b': nrm(ks[17], (nb, LRU_WIDTH), 0.01),
        'lru_w_gx': nrm(ks[18], (nb, LRU_HEADS, LRU_BLOCK, LRU_BLOCK), LRU_BLOCK ** -0.5),
        'lru_b_gx': nrm(ks[19], (nb, LRU_WIDTH), 0.01),
        'lru_w_ga': nrm(ks[21], (nb, LRU_HEADS, LRU_BLOCK, LRU_BLOCK), LRU_BLOCK ** -0.5),
        'lru_b_ga': nrm(ks[22], (nb, LRU_WIDTH), 0.01),
        'lru_lambda': jnp.log(lam_u) - jnp.log1p(-lam_u),
        'lru_w_out': nrm(ks[23], (nb, LRU_WIDTH, D_MODEL), LRU_WIDTH ** -0.5),
        'lru_b_out': nrm(ks[24], (nb, D_MODEL), 0.01),
        'ffn_w_up': nrm(ks[25], (DEPTH, D_MODEL, 2 * D_FF), D_MODEL ** -0.5),
        'ffn_conv_w': nrm(ks[26], (DEPTH, FFN_CONV, 2 * D_FF), FFN_CONV ** -0.5),
        'ffn_conv_b': nrm(ks[27], (DEPTH, 2 * D_FF), 0.01),
        'ffn_w_down': nrm(ks[28], (DEPTH, D_FF, D_MODEL), D_FF ** -0.5),
    }


def reference(x, norm_mix_pre, norm_mix_post, norm_ffn_pre, norm_ffn_post,
              ssd_w_in, ssd_conv_w, ssd_conv_b, ssd_dt_bias, ssd_a_log, ssd_d, ssd_norm, ssd_w_out,
              lru_w_in, lru_b_in, lru_conv_w, lru_conv_b, lru_w_gx, lru_b_gx, lru_w_ga, lru_b_ga,
              lru_lambda, lru_w_out, lru_b_out,
              ffn_w_up, ffn_conv_w, ffn_conv_b, ffn_w_down):
    for i in range(DEPTH):
        h = rmsnorm(x, norm_mix_pre[i])
        j = i // N_MIXERS
        if i % N_MIXERS == 0:
            m = ssd_mixer(h, ssd_w_in[j], ssd_conv_w[j], ssd_conv_b[j], ssd_dt_bias[j],
                          ssd_a_log[j], ssd_d[j], ssd_norm[j], ssd_w_out[j])
        else:
            m = rglru_mixer(h, lru_w_in[j], lru_b_in[j], lru_conv_w[j], lru_conv_b[j],
                            lru_w_gx[j], lru_b_gx[j], lru_w_ga[j], lru_b_ga[j],
                            lru_lambda[j], lru_w_out[j], lru_b_out[j])
        x = x + rmsnorm(m, norm_mix_post[i])
        h = rmsnorm(x, norm_ffn_pre[i])
        f = conv_ffn(h, ffn_w_up[i], ffn_conv_w[i], ffn_conv_b[i], ffn_w_down[i])
        x = x + rmsnorm(f, norm_ffn_post[i])
    return x
```

```cpp
#include <hip/hip_runtime.h>
#include <hip/hip_cooperative_groups.h>
#include <cstdio>
namespace cg = cooperative_groups;

#ifndef ONE_LAUNCH
#define ONE_LAUNCH 0
#endif

#define LAS __attribute__((address_space(3)))
typedef unsigned short bf16_t;
typedef short bf16x8 __attribute__((ext_vector_type(8)));
typedef float f32x4 __attribute__((ext_vector_type(4)));
typedef unsigned u32x4 __attribute__((ext_vector_type(4)));
typedef unsigned u32x2 __attribute__((ext_vector_type(2)));

constexpr int T = 32768, DM = 1024;
constexpr float EPS = 1e-6f;
constexpr int NPHASE = 37;
constexpr int LDS_BYTES = 147456;
constexpr int XCH_OFF = 131072;

constexpr size_t WS_H    = 8192;
constexpr size_t H_BYTES = (size_t)33024 * 2048;
constexpr size_t WS_M    = WS_H + H_BYTES;
constexpr size_t WS_ST   = WS_H;
constexpr size_t WS_PROJ = WS_M + (size_t)T * 2048;
constexpr size_t WS_DT   = WS_PROJ + (size_t)T * 5120 * 2;
constexpr size_t WS_WIN  = WS_DT + (size_t)T * 32 * 4;
constexpr size_t WS_WOUT = WS_WIN + (size_t)5376 * 1024 * 2;
constexpr size_t WS_WG   = WS_WOUT + (size_t)2048 * 1024 * 2;
constexpr size_t WS_WUP  = WS_WG + (size_t)10 * 256 * 128 * 2;
constexpr size_t WS_WDN  = WS_WUP + (size_t)8192 * 1024 * 2;
constexpr size_t WS_RSM  = WS_WDN + (size_t)4096 * 1024 * 2;
constexpr size_t WS_RSF  = WS_RSM + (size_t)T * 64;
constexpr size_t WS_TOT  = WS_RSF + (size_t)T * 64;
constexpr size_t WS_AGG  = WS_TOT + 32768;
constexpr size_t WS_CAR  = WS_AGG + (size_t)8 * 32 * 1280 * 8;
constexpr size_t WS_END  = WS_CAR + (size_t)8 * 32 * 1280 * 4;
constexpr size_t LRU_HY_OFF = (size_t)T * 2560 * 2;

struct Params { const float* in[28]; float* out; unsigned char* ws; int ph_lo, ph_hi; };

typedef __bf16 bf16v2_t __attribute__((ext_vector_type(2)));
typedef float f32v2_t __attribute__((ext_vector_type(2)));
__device__ __forceinline__ unsigned cvt_pk_bf16(float lo, float hi) { f32v2_t v = {lo, hi}; bf16v2_t b = __builtin_convertvector(v, bf16v2_t); return __builtin_bit_cast(unsigned, b); }
__device__ __forceinline__ float bf_lo(unsigned w) { return __uint_as_float(w << 16); }
__device__ __forceinline__ float bf_hi(unsigned w) { return __uint_as_float(w & 0xffff0000u); }
__device__ __forceinline__ float bf2f(bf16_t b) { return __uint_as_float(((unsigned)b) << 16); }
__device__ __forceinline__ bf16_t f2bf(float f) { return (bf16_t)(cvt_pk_bf16(f, 0.f) & 0xffffu); }
__device__ __forceinline__ float sigmoidf_(float x) { return __builtin_amdgcn_rcpf(1.f + __builtin_amdgcn_exp2f(-1.44269504f * x)); }
__device__ __forceinline__ float siluf_(float x) { return x * sigmoidf_(x); }
__device__ __forceinline__ float geluf_(float x) { return x * __builtin_amdgcn_rcpf(1.f + __builtin_amdgcn_exp2f(-2.302208198f * x * (1.f + 0.044715f * x * x))); }
__device__ __forceinline__ float softplusf_(float x) { return fmaxf(x, 0.f) + log1pf(expf(-fabsf(x))); }
template <int CTRL> __device__ __forceinline__ float dppf(float oldv, float src) {
    return __builtin_bit_cast(float, __builtin_amdgcn_update_dpp(__builtin_bit_cast(int, oldv), __builtin_bit_cast(int, src), CTRL, 0xf, 0xf, false));
}
__device__ __forceinline__ int otid() { int t = threadIdx.x; asm volatile("" : "+v"(t)); return t; }
__device__ __forceinline__ int obid() { int t = blockIdx.x; asm volatile("" : "+s"(t)); return t; }
__device__ __forceinline__ bf16x8 ldfrag(const LAS bf16_t* base, int stride, int row, int kb, int q) { return *(const LAS bf16x8*)(base + row * stride + kb * 32 + q * 8); }

constexpr int BM = 256, BK = 64, HALF = 128, HTB = HALF * BK * 2, NXCD = 8, WGM = 8;
__device__ __forceinline__ int lds_byte(int r, int c) { const int st = (r >> 4) * 2 + (c >> 5), rr = r & 15, cc = c & 31, ob = rr * 64 + cc * 2; return st * 1024 + (ob ^ (((ob >> 9) & 1) << 5)); }
__device__ __forceinline__ void stage_rc(int b, int& R, int& C) { const int st = b / 1024, sb = b % 1024, swz = sb ^ (((sb >> 9) & 1) << 5); R = (st >> 1) * 16 + swz / 64; C = (st & 1) * 32 + (swz % 64) / 2; }
__device__ __forceinline__ int perm32(int rho) { const int n = rho >> 4, i = rho & 15; return 8 * (i >> 2) + 4 * n + (i & 3); }

struct Unit { int pm, pn; };
struct Gemm { const bf16_t* A; const bf16_t* Bt; int K, lda, ldb, nM, nN, rowsPerUnit; };
struct Sched {
    int nM, nN, nwg, G, c;
    __device__ void init(int nM_, int nN_, int G_, int c_) { nM = nM_; nN = nN_; nwg = nM * nN; G = G_; c = c_; }
    __device__ bool next(int i, Unit& u) const {
        const long L = (long)i * G + c; if (L >= nwg) return false;
        int wgid = (int)L; { const int q = nwg / NXCD, r = nwg % NXCD, xcd = wgid % NXCD, off = wgid / NXCD; wgid = (xcd < r ? xcd * (q + 1) : r * (q + 1) + (xcd - r) * q) + off; }
        const int nig = WGM * nN, gid = wgid / nig, fm = gid * WGM, gsz = (nM - fm) < WGM ? (nM - fm) : WGM;
        u.pm = fm + ((wgid % nig) % gsz); u.pn = (wgid % nig) / gsz; return true;
    }
};

struct EpiStore {
    static constexpr bool PERM = true, ROWIL = false;
    bf16_t* O; int ldc; const float* bias; int dt_tile; float* DT; float* rowss;
    __device__ __forceinline__ void operator()(f32x4 (&acc)[2][2][4][2], const Unit& u, int wr, int wc, int fr, int fq, LAS unsigned char*) const {
        const int row0 = u.pm * BM + wr * 64 + fr;
        if (u.pn == dt_tile) {
            if (wc == 0) {
#pragma unroll
                for (int ai = 0; ai < 2; ++ai)
#pragma unroll
                    for (int m = 0; m < 4; ++m) {
                        float* rp = DT + (size_t)(row0 + ai * HALF + m * 16) * 32 + 8 * fq;
                        *(f32x4*)rp = acc[ai][0][m][0]; *(f32x4*)(rp + 4) = acc[ai][0][m][1];
                    }
            }
            return;
        }
        const int col0 = u.pn * BM + wc * 32 + 8 * fq;
        f32x4 bv[2][2];
#pragma unroll
        for (int bj = 0; bj < 2; ++bj)
#pragma unroll
            for (int n = 0; n < 2; ++n) bv[bj][n] = bias ? *(const f32x4*)(bias + col0 + bj * HALF + 4 * n) : (f32x4){0.f, 0.f, 0.f, 0.f};
#pragma unroll
        for (int ai = 0; ai < 2; ++ai)
#pragma unroll
            for (int m = 0; m < 4; ++m) {
                const int row = row0 + ai * HALF + m * 16;
                bf16_t* rowp = O + (size_t)row * ldc + col0;
                float ss = 0.f;
#pragma unroll
                for (int bj = 0; bj < 2; ++bj) {
                    const f32x4 v0 = acc[ai][bj][m][0] + bv[bj][0], v1 = acc[ai][bj][m][1] + bv[bj][1];
                    ss += (v0[0] * v0[0] + v0[1] * v0[1]) + (v0[2] * v0[2] + v0[3] * v0[3]) + (v1[0] * v1[0] + v1[1] * v1[1]) + (v1[2] * v1[2] + v1[3] * v1[3]);
                    u32x4 w; w.x = cvt_pk_bf16(v0[0], v0[1]); w.y = cvt_pk_bf16(v0[2], v0[3]); w.z = cvt_pk_bf16(v1[0], v1[1]); w.w = cvt_pk_bf16(v1[2], v1[3]);
                    *(u32x4*)(rowp + bj * HALF) = w;
                }
                if (rowss) {
                    ss += __shfl_xor(ss, 16); ss += __shfl_xor(ss, 32);
                    if (fq == 0) rowss[(size_t)row * 16 + u.pn * 4 + wc] = ss;
                }
            }
    }
};

struct EpiFfnUp {
    static constexpr bool PERM = true, ROWIL = true;
    bf16_t* O; const float* cw; const float* cb;
    __device__ __forceinline__ void operator()(f32x4 (&acc)[2][2][4][2], const Unit& u, int wr, int wc, int fr, int fq, LAS unsigned char* xl) const {
        LAS f32x4* X = (LAS f32x4*)xl;
        if (wr == 0 && fr >= 14) {
#pragma unroll
            for (int bj = 0; bj < 2; ++bj)
#pragma unroll
                for (int n = 0; n < 2; ++n) X[(((wc * 2 + bj) * 2 + n) * 4 + fq) * 2 + (fr - 14)] = acc[1][bj][3][n];
        }
        asm volatile("s_waitcnt lgkmcnt(0)" ::: "memory"); __builtin_amdgcn_s_barrier(); asm volatile("" ::: "memory");
        const int chb = u.pn * 128 + wc * 32 + fq * 8;
        const int tok0 = u.pm * 254 - 2 + wr * 128 + fr;
        const LAS float* Xf = (const LAS float*)xl;
#pragma unroll
        for (int n = 0; n < 2; ++n) {
#pragma unroll
            for (int ip = 0; ip < 2; ++ip) {
                float w0g[2], w1g[2], w2g[2], bg[2], w0v[2], w1v[2], w2v[2], bvv[2], eg14[2], eg15[2], ev14[2], ev15[2];
#pragma unroll
                for (int ii = 0; ii < 2; ++ii) {
                    const int i = ip * 2 + ii, ch = chb + 4 * n + i;
                    w0g[ii] = cw[ch]; w1g[ii] = cw[8192 + ch]; w2g[ii] = cw[16384 + ch]; bg[ii] = cb[ch];
                    w0v[ii] = cw[4096 + ch]; w1v[ii] = cw[8192 + 4096 + ch]; w2v[ii] = cw[16384 + 4096 + ch]; bvv[ii] = cb[4096 + ch];
                    eg14[ii] = Xf[((((wc * 2 + 0) * 2 + n) * 4 + fq) * 2 + 0) * 4 + i]; eg15[ii] = Xf[((((wc * 2 + 0) * 2 + n) * 4 + fq) * 2 + 1) * 4 + i];
                    ev14[ii] = Xf[((((wc * 2 + 1) * 2 + n) * 4 + fq) * 2 + 0) * 4 + i]; ev15[ii] = Xf[((((wc * 2 + 1) * 2 + n) * 4 + fq) * 2 + 1) * 4 + i];
                }
                __builtin_amdgcn_sched_barrier(0);
#pragma unroll
                for (int ai = 1; ai >= 0; --ai)
#pragma unroll
                    for (int m = 3; m >= 0; --m) {
                        const bool hasP = !(ai == 0 && m == 0);
                        const int tok = tok0 + ai * 64 + m * 16, spos = tok & 4095;
                        const float m1 = (spos != 0) ? 1.f : 0.f, m2 = (spos > 1) ? 1.f : 0.f;
#pragma unroll
                        for (int ii = 0; ii < 2; ++ii) {
                            const int i = ip * 2 + ii;
                            const float Pg = m > 0 ? acc[ai][0][m - 1][n][i] : acc[0][0][3][n][i];
                            const float Pv = m > 0 ? acc[ai][1][m - 1][n][i] : acc[0][1][3][n][i];
                            const float cgv = acc[ai][0][m][n][i], cvv = acc[ai][1][m][n][i];
                            float o1g, o2g, o1v, o2v;
                            if (hasP) { o1g = dppf<0x121>(0.f, Pg); o2g = dppf<0x122>(0.f, Pg); o1v = dppf<0x121>(0.f, Pv); o2v = dppf<0x122>(0.f, Pv); }
                            else { o1g = eg15[ii]; o2g = (fr == 1) ? eg15[ii] : eg14[ii]; o1v = ev15[ii]; o2v = (fr == 1) ? ev15[ii] : ev14[ii]; }
                            const float p1g = dppf<0x111>(o1g, cgv), p2g = dppf<0x112>(o2g, cgv);
                            const float p1v = dppf<0x111>(o1v, cvv), p2v = dppf<0x112>(o2v, cvv);
                            const float gg = bg[ii] + w2g[ii] * cgv + (w1g[ii] * m1) * p1g + (w0g[ii] * m2) * p2g;
                            const float vv = bvv[ii] + w2v[ii] * cvv + (w1v[ii] * m1) * p1v + (w0v[ii] * m2) * p2v;
                            float rv = geluf_(gg) * vv;
                            asm volatile("" : "+v"(rv));
                            acc[ai][0][m][n][i] = rv;
                        }
                        __builtin_amdgcn_sched_barrier(0);
                    }
            }
#pragma unroll
            for (int ai = 0; ai < 2; ++ai)
#pragma unroll
                for (int m = 0; m < 4; ++m) {
                    const int ru = wr * 128 + ai * 64 + m * 16 + fr, tok = u.pm * 254 - 2 + ru;
                    if (ru >= 2 && tok < T) {
                        const f32x4 v0 = acc[ai][0][m][n];
                        u32x2 w; w.x = cvt_pk_bf16(v0[0], v0[1]); w.y = cvt_pk_bf16(v0[2], v0[3]);
                        *(u32x2*)(O + (size_t)tok * 4096 + chb + 4 * n) = w;
                    }
                }
            __builtin_amdgcn_sched_barrier(0);
        }
    }
};

template <class Epi>
__device__ __forceinline__ void gemm_phase(LAS unsigned char* lds, const Gemm g, const Epi& E) {
    const int tid = otid(), wid = __builtin_amdgcn_readfirstlane(tid >> 6), lane = tid & 63, wr = wid >> 2, wc = wid & 3, fr = lane & 15, fq = lane >> 4;
    const int K = g.K, nt = K / BK;
    Sched S; S.init(g.nM, g.nN, (int)gridDim.x, obid());
    unsigned voffA[2], voffB[2];
#pragma unroll
    for (int i = 0; i < 2; ++i) { int R, C; stage_rc(tid * 16 + i * 8192, R, C);
        const int Ra = Epi::ROWIL ? ((R >> 6) * 128 + (R & 63)) : R;
        const int Rb = Epi::PERM ? ((R & ~31) + perm32(R & 31)) : R;
        voffA[i] = (unsigned)(Ra * g.lda + C) * 2u; voffB[i] = (unsigned)(Rb * g.ldb + C) * 2u; }
    const size_t kstep = (size_t)(BK * 2);
    const size_t hstepA = (size_t)(Epi::ROWIL ? 64 : HALF) * g.lda * 2, hstepB = (size_t)HALF * g.ldb * 2;
    const size_t tstepA = (size_t)g.rowsPerUnit * g.lda * 2, tstepB = (size_t)BM * g.ldb * 2;
    const unsigned ldsw = (unsigned)wid * 1024u;
    const int aoff = lds_byte(wr * 64 + fr, fq * 8), boff = lds_byte(wc * 32 + fr, fq * 8);
#define PG8_SA(b, h) (((b) * 2 + (h)) * HTB)
#define PG8_SB(b, h) ((4 + (b) * 2 + (h)) * HTB)
#define PG8_STAGE(bufoff, gbase, voff) do { _Pragma("unroll") for (int _i = 0; _i < 2; ++_i) \
        __builtin_amdgcn_global_load_lds((const unsigned*)((const char*)(gbase) + (voff)[_i]), (LAS unsigned*)(lds + (bufoff) + ldsw + _i * 8192), 16, 0, 0); } while (0)
#define PG8_LDA(dst, b, h) do { _Pragma("unroll") for (int m = 0; m < 4; ++m) _Pragma("unroll") for (int k = 0; k < 2; ++k) dst[m][k] = *(const LAS bf16x8*)(lds + PG8_SA(b, h) + aoff + m * 2048 + k * 1024); } while (0)
#define PG8_LDB(dst, b, h) do { _Pragma("unroll") for (int n = 0; n < 2; ++n) _Pragma("unroll") for (int k = 0; k < 2; ++k) dst[n][k] = *(const LAS bf16x8*)(lds + PG8_SB(b, h) + boff + n * 2048 + k * 1024); } while (0)
#define PG8_MMA(ai, bj, At, Bt) do { __builtin_amdgcn_s_setprio(1); _Pragma("unroll") for (int m = 0; m < 4; ++m) _Pragma("unroll") for (int n = 0; n < 2; ++n) _Pragma("unroll") for (int k = 0; k < 2; ++k) \
        acc[ai][bj][m][n] = __builtin_amdgcn_mfma_f32_16x16x32_bf16(Bt[n][k], At[m][k], acc[ai][bj][m][n], 0, 0, 0); __builtin_amdgcn_s_setprio(0); } while (0)
#define PG8_WAIT_V(n) asm volatile("s_waitcnt vmcnt(" #n ")" ::: "memory")
#define PG8_WAIT_L(n) asm volatile("s_waitcnt lgkmcnt(" #n ")" ::: "memory")
#define PG8_BAR __builtin_amdgcn_s_barrier()
#define PG8_SCHED __builtin_amdgcn_sched_barrier(0)
    Unit cur, nxt; int ui = 0;
    if (!S.next(0, cur)) return;
    f32x4 acc[2][2][4][2];
#pragma unroll
    for (int a = 0; a < 2; ++a)
#pragma unroll
        for (int b = 0; b < 2; ++b)
#pragma unroll
            for (int m = 0; m < 4; ++m)
#pragma unroll
                for (int n = 0; n < 2; ++n) acc[a][b][m][n] = (f32x4){0.f, 0.f, 0.f, 0.f};
    bf16x8 At[4][2], B0[2][2], B1[2][2];
    const char* cA = (const char*)g.A + (size_t)cur.pm * tstepA; const char* cB = (const char*)g.Bt + (size_t)cur.pn * tstepB;
    PG8_STAGE(PG8_SB(0, 0), cB, voffB); PG8_STAGE(PG8_SA(0, 0), cA, voffA); PG8_STAGE(PG8_SB(0, 1), cB + hstepB, voffB); PG8_STAGE(PG8_SA(0, 1), cA + hstepA, voffA);
    if (wr == 1) PG8_BAR;
    PG8_WAIT_V(4); PG8_BAR;
    PG8_STAGE(PG8_SB(1, 0), cB + kstep, voffB); PG8_STAGE(PG8_SA(1, 0), cA + kstep, voffA); PG8_STAGE(PG8_SB(1, 1), cB + hstepB + kstep, voffB);
    PG8_WAIT_V(6); PG8_BAR;
    for (;;) {
        const bool has_next = S.next(ui + 1, nxt);
        const char* nA = has_next ? (const char*)g.A + (size_t)nxt.pm * tstepA : cA; const char* nB = has_next ? (const char*)g.Bt + (size_t)nxt.pn * tstepB : cB;
        for (int t = 0; t < nt; t += 2) {
            const bool last = (t == nt - 2);
            const char* a1 = cA + (size_t)(t + 1) * kstep;
            const char* a2 = last ? nA : cA + (size_t)(t + 2) * kstep; const char* b2 = last ? nB : cB + (size_t)(t + 2) * kstep;
            const char* a3 = a2 + kstep; const char* b3 = b2 + kstep;
            PG8_LDB(B0, 0, 0); PG8_SCHED; PG8_LDA(At, 0, 0); PG8_STAGE(PG8_SA(1, 1), a1 + hstepA, voffA);
            PG8_WAIT_L(8); PG8_BAR; PG8_WAIT_L(0); PG8_MMA(0, 0, At, B0); PG8_BAR; PG8_SCHED;
            PG8_LDB(B1, 0, 1); PG8_STAGE(PG8_SB(0, 0), b2, voffB);
            PG8_BAR; PG8_WAIT_L(0); PG8_MMA(0, 1, At, B1); PG8_BAR;
            PG8_LDA(At, 0, 1); PG8_STAGE(PG8_SA(0, 0), a2, voffA);
            PG8_BAR; PG8_WAIT_L(0); PG8_MMA(1, 0, At, B0); PG8_BAR; PG8_SCHED;
            PG8_STAGE(PG8_SB(0, 1), b2 + hstepB, voffB);
            PG8_WAIT_V(6); PG8_BAR; PG8_MMA(1, 1, At, B1); PG8_BAR;
            PG8_LDB(B0, 1, 0); PG8_SCHED; PG8_LDA(At, 1, 0); PG8_STAGE(PG8_SA(0, 1), a2 + hstepA, voffA);
            PG8_WAIT_L(8); PG8_BAR; PG8_WAIT_L(0); PG8_MMA(0, 0, At, B0); PG8_BAR; PG8_SCHED;
            PG8_LDB(B1, 1, 1); PG8_STAGE(PG8_SB(1, 0), b3, voffB);
            PG8_BAR; PG8_WAIT_L(0); PG8_MMA(0, 1, At, B1); PG8_BAR;
            PG8_LDA(At, 1, 1); PG8_STAGE(PG8_SA(1, 0), a3, voffA);
            PG8_BAR; PG8_WAIT_L(0); PG8_MMA(1, 0, At, B0); PG8_BAR; PG8_SCHED;
            PG8_STAGE(PG8_SB(1, 1), b3 + hstepB, voffB);
            PG8_WAIT_V(6); PG8_BAR; PG8_MMA(1, 1, At, B1); PG8_BAR;
        }
        E(acc, cur, wr, wc, fr, fq, lds + XCH_OFF);
        if (!has_next) break;
#pragma unroll
        for (int a = 0; a < 2; ++a)
#pragma unroll
            for (int b = 0; b < 2; ++b)
#pragma unroll
                for (int m = 0; m < 4; ++m)
#pragma unroll
                    for (int n = 0; n < 2; ++n) acc[a][b][m][n] = (f32x4){0.f, 0.f, 0.f, 0.f};
        cur = nxt; cA = nA; cB = nB; ++ui;
    }
    PG8_WAIT_V(0);
    if (wr == 0) PG8_BAR;
    PG8_BAR;
#undef PG8_SA
#undef PG8_SB
#undef PG8_STAGE
#undef PG8_LDA
#undef PG8_LDB
#undef PG8_MMA
#undef PG8_WAIT_V
#undef PG8_WAIT_L
#undef PG8_BAR
#undef PG8_SCHED
}

__device__ void cvt_weight(const float* src, int K, int Nsrc, bf16_t* dst, int Ndst, int mode, LAS unsigned char* lds) {
    LAS float* tile = (LAS float*)lds;
    const int tid = otid(), ntn = Ndst >> 6, ntiles = ntn * (K >> 6);
    for (int id = obid(); id < ntiles; id += gridDim.x) {
        const int tn = id % ntn, tk = id / ntn, n0 = tn * 64, k0 = tk * 64;
        int sc0;
        if (mode == 1) { const int pn = n0 >> 8, bj = (n0 >> 7) & 1, j = n0 & 127; sc0 = bj * 4096 + pn * 128 + j; } else sc0 = n0;
        {
            const int r = tid >> 4, c4 = (tid & 15) * 4;
#pragma unroll
            for (int i = 0; i < 2; ++i) {
                const int kk = r + 32 * i;
                f32x4 v = {0.f, 0.f, 0.f, 0.f};
                if (sc0 + c4 + 3 < Nsrc) v = *(const f32x4*)(src + (size_t)(k0 + kk) * Nsrc + sc0 + c4);
                tile[kk * 65 + c4] = v[0]; tile[kk * 65 + c4 + 1] = v[1]; tile[kk * 65 + c4 + 2] = v[2]; tile[kk * 65 + c4 + 3] = v[3];
            }
        }
        __syncthreads();
        {
            const int n = tid >> 3, k8 = (tid & 7) * 8;
            float f[8];
#pragma unroll
            for (int j = 0; j < 8; ++j) f[j] = tile[(k8 + j) * 65 + n];
            u32x4 w; w.x = cvt_pk_bf16(f[0], f[1]); w.y = cvt_pk_bf16(f[2], f[3]); w.z = cvt_pk_bf16(f[4], f[5]); w.w = cvt_pk_bf16(f[6], f[7]);
            *(u32x4*)(dst + (size_t)(n0 + n) * K + k0 + k8) = w;
        }
        __syncthreads();
    }
}

__device__ void cvt_mixer_weights(const Params& p, int layer, LAS unsigned char* lds) {
    unsigned char* ws = p.ws; const int j = layer >> 1;
    if ((layer & 1) == 0) {
        cvt_weight(p.in[5] + (size_t)j * 1024 * 5152, 1024, 5152, (bf16_t*)(ws + WS_WIN), 5376, 0, lds);
        cvt_weight(p.in[12] + (size_t)j * 2048 * 1024, 2048, 1024, (bf16_t*)(ws + WS_WOUT), 1024, 0, lds);
    } else {
        cvt_weight(p.in[13] + (size_t)j * 1024 * 2560, 1024, 2560, (bf16_t*)(ws + WS_WIN), 2560, 0, lds);
        cvt_weight(p.in[22] + (size_t)j * 1280 * 1024, 1280, 1024, (bf16_t*)(ws + WS_WOUT), 1024, 0, lds);
        for (int h = 0; h < 10; ++h) {
            cvt_weight(p.in[17] + (size_t)(j * 10 + h) * 16384, 128, 128, (bf16_t*)(ws + WS_WG) + (size_t)(h * 256) * 128, 128, 0, lds);
            cvt_weight(p.in[19] + (size_t)(j * 10 + h) * 16384, 128, 128, (bf16_t*)(ws + WS_WG) + (size_t)(h * 256 + 128) * 128, 128, 0, lds);
        }
    }
}
__device__ void cvt_ffn_weights(const Params& p, int layer, LAS unsigned char* lds) {
    unsigned char* ws = p.ws;
    cvt_weight(p.in[24] + (size_t)layer * 1024 * 8192, 1024, 8192, (bf16_t*)(ws + WS_WUP), 8192, 1, lds);
    cvt_weight(p.in[27] + (size_t)layer * 4096 * 1024, 4096, 1024, (bf16_t*)(ws + WS_WDN), 1024, 0, lds);
}

__device__ void ph_resnorm(const float* xin, float* xout, const bf16_t* mb, const float* rss, const float* wpost, const float* wpre, bf16_t* H) {
    const int tid_ = otid(), wave = tid_ >> 6, lane = tid_ & 63;
    for (int row = obid() * 8 + wave; row < T; row += gridDim.x * 8) {
        float rs = 0.f;
        if (mb) {
            const f32x4 r0 = *(const f32x4*)(rss + (size_t)row * 16), r1 = *(const f32x4*)(rss + (size_t)row * 16 + 4), r2 = *(const f32x4*)(rss + (size_t)row * 16 + 8), r3 = *(const f32x4*)(rss + (size_t)row * 16 + 12);
            const float tot = (((r0[0] + r0[1]) + (r0[2] + r0[3])) + ((r1[0] + r1[1]) + (r1[2] + r1[3]))) + (((r2[0] + r2[1]) + (r2[2] + r2[3])) + ((r3[0] + r3[1]) + (r3[2] + r3[3])));
            rs = rsqrtf(tot * (1.f / 1024.f) + EPS);
        }
        float v[16];
#pragma unroll
        for (int j = 0; j < 2; ++j) {
            const int col0 = j * 512 + lane * 8;
            const f32x4 x0 = *(const f32x4*)(xin + (size_t)row * 1024 + col0), x1 = *(const f32x4*)(xin + (size_t)row * 1024 + col0 + 4);
            v[j * 8 + 0] = x0[0]; v[j * 8 + 1] = x0[1]; v[j * 8 + 2] = x0[2]; v[j * 8 + 3] = x0[3];
            v[j * 8 + 4] = x1[0]; v[j * 8 + 5] = x1[1]; v[j * 8 + 6] = x1[2]; v[j * 8 + 7] = x1[3];
            if (mb) {
                const u32x4 mm = *(const u32x4*)(mb + (size_t)row * 1024 + col0);
                const f32x4 w0 = *(const f32x4*)(wpost + col0), w1 = *(const f32x4*)(wpost + col0 + 4);
                v[j * 8 + 0] += bf_lo(mm.x) * rs * w0[0]; v[j * 8 + 1] += bf_hi(mm.x) * rs * w0[1];
                v[j * 8 + 2] += bf_lo(mm.y) * rs * w0[2]; v[j * 8 + 3] += bf_hi(mm.y) * rs * w0[3];
                v[j * 8 + 4] += bf_lo(mm.z) * rs * w1[0]; v[j * 8 + 5] += bf_hi(mm.z) * rs * w1[1];
                v[j * 8 + 6] += bf_lo(mm.w) * rs * w1[2]; v[j * 8 + 7] += bf_hi(mm.w) * rs * w1[3];
            }
            if (xout) {
                *(f32x4*)(xout + (size_t)row * 1024 + col0) = (f32x4){v[j * 8 + 0], v[j * 8 + 1], v[j * 8 + 2], v[j * 8 + 3]};
                *(f32x4*)(xout + (size_t)row * 1024 + col0 + 4) = (f32x4){v[j * 8 + 4], v[j * 8 + 5], v[j * 8 + 6], v[j * 8 + 7]};
            }
        }
        if (wpre) {
            float ss = 0.f;
#pragma unroll
            for (int i = 0; i < 16; ++i) ss += v[i] * v[i];
#pragma unroll
            for (int o = 32; o >= 1; o >>= 1) ss += __shfl_xor(ss, o);
            const float r2 = rsqrtf(ss * (1.f / 1024.f) + EPS);
#pragma unroll
            for (int j = 0; j < 2; ++j) {
                const int col0 = j * 512 + lane * 8;
                const f32x4 w0 = *(const f32x4*)(wpre + col0), w1 = *(const f32x4*)(wpre + col0 + 4);
                u32x4 w;
                w.x = cvt_pk_bf16(v[j * 8 + 0] * r2 * w0[0], v[j * 8 + 1] * r2 * w0[1]); w.y = cvt_pk_bf16(v[j * 8 + 2] * r2 * w0[2], v[j * 8 + 3] * r2 * w0[3]);
                w.z = cvt_pk_bf16(v[j * 8 + 4] * r2 * w1[0], v[j * 8 + 5] * r2 * w1[1]); w.w = cvt_pk_bf16(v[j * 8 + 6] * r2 * w1[2], v[j * 8 + 7] * r2 * w1[3]);
                *(u32x4*)(H + (size_t)row * 1024 + col0) = w;
            }
        }
    }
}

template <int KT>
__device__ __forceinline__ void conv8(const bf16_t* src, int ld, size_t t, int spos, int col, const float* w, int wstride, const float* bias, int cc, float (&o)[8]) {
    const f32x4 b0 = *(const f32x4*)(bias + cc), b1 = *(const f32x4*)(bias + cc + 4);
    o[0] = b0[0]; o[1] = b0[1]; o[2] = b0[2]; o[3] = b0[3]; o[4] = b1[0]; o[5] = b1[1]; o[6] = b1[2]; o[7] = b1[3];
#pragma unroll
    for (int j = 0; j < KT; ++j) {
        const int back = KT - 1 - j;
        if (spos - back >= 0) {
            const u32x4 v = *(const u32x4*)(src + (t - back) * ld + col);
            const f32x4 w0 = *(const f32x4*)(w + j * wstride + cc), w1 = *(const f32x4*)(w + j * wstride + cc + 4);
            o[0] += w0[0] * bf_lo(v.x); o[1] += w0[1] * bf_hi(v.x); o[2] += w0[2] * bf_lo(v.y); o[3] += w0[3] * bf_hi(v.y);
            o[4] += w1[0] * bf_lo(v.z); o[5] += w1[1] * bf_hi(v.z); o[6] += w1[2] * bf_lo(v.w); o[7] += w1[3] * bf_hi(v.w);
        }
    }
}

__device__ __forceinline__ void ssd_cs(const float* DTb, const float* dt_bias, const float* a_log, size_t t0, int g, LAS float* csL, LAS float* dtL, float* tot_out) {
    const int tid_ = otid(), w = tid_ >> 6, lane = tid_ & 63, h = g * 8 + w;
    const float a = -expf(a_log[h]), bias = dt_bias[h];
    const float d0 = softplusf_(DTb[(t0 + 2 * lane) * 32 + h] + bias), d1 = softplusf_(DTb[(t0 + 2 * lane + 1) * 32 + h] + bias);
    const float s0 = d0 * a, s1 = s0 + d1 * a;
    float inc = s1;
#pragma unroll
    for (int o = 1; o < 64; o <<= 1) { const float tv = __shfl_up(inc, o); if (lane >= o) inc += tv; }
    const float excl = inc - s1;
    csL[w * 128 + 2 * lane] = excl + s0; csL[w * 128 + 2 * lane + 1] = excl + s1;
    dtL[w * 128 + 2 * lane] = d0; dtL[w * 128 + 2 * lane + 1] = d1;
    if (tot_out && lane == 63) tot_out[h] = inc;
}

__device__ void ph_ssd_states(const Params& p, int j, LAS unsigned char* lds) {
    LAS bf16_t* Bt_s = (LAS bf16_t*)lds;
    LAS bf16_t* xT = (LAS bf16_t*)(lds + 34816);
    LAS float* csL = (LAS float*)(lds + 34816 + 17408);
    LAS float* dtL = csL + 1024;
    const bf16_t* PROJ = (const bf16_t*)(p.ws + WS_PROJ); const float* DTb = (const float*)(p.ws + WS_DT);
    bf16_t* ST = (bf16_t*)(p.ws + WS_ST); float* TOT = (float*)(p.ws + WS_TOT);
    const float* conv_w = p.in[6] + (size_t)j * 4 * 3072; const float* conv_b = p.in[7] + (size_t)j * 3072;
    const float* dt_bias = p.in[8] + j * 32; const float* a_log = p.in[9] + j * 32;
    const int tid = otid(), w = tid >> 6, lane = tid & 63, fr = lane & 15, q = lane >> 4;
    for (int item = obid(); item < 1024; item += gridDim.x) {
        const int b = item >> 7, c = (item >> 2) & 31, g = item & 3;
        const size_t t0 = (size_t)b * 4096 + c * 128;
        ssd_cs(DTb, dt_bias, a_log, t0, g, csL, dtL, TOT + (b * 32 + c) * 32);
        for (int idx = tid; idx < 64 * 16; idx += 512) {
            const int l = (idx >> 4) * 2, n8 = (idx & 15) * 8, cc = 2048 + g * 128 + n8;
            float v[8], v1[8]; conv8<4>(PROJ, 5120, t0 + l, c * 128 + l, 2048 + cc, conv_w, 3072, conv_b, cc, v);
            conv8<4>(PROJ, 5120, t0 + l + 1, c * 128 + l + 1, 2048 + cc, conv_w, 3072, conv_b, cc, v1);
#pragma unroll
            for (int e = 0; e < 8; ++e) *(LAS unsigned*)(Bt_s + (n8 + e) * 136 + l) = cvt_pk_bf16(siluf_(v[e]), siluf_(v1[e]));
        }
        __syncthreads();
#ifdef DBG_S1_NOE
        continue;
#endif
        for (int e = 0; e < 8; ++e) {
            const int h = g * 8 + e;
            const float cl = csL[e * 128 + 127];
            {
                const int l = (tid >> 3) * 2, p8 = (tid & 7) * 8, cc = h * 64 + p8;
                float v[8], v1[8]; conv8<4>(PROJ, 5120, t0 + l, c * 128 + l, 2048 + cc, conv_w, 3072, conv_b, cc, v);
                conv8<4>(PROJ, 5120, t0 + l + 1, c * 128 + l + 1, 2048 + cc, conv_w, 3072, conv_b, cc, v1);
                const float sc = dtL[e * 128 + l] * __expf(cl - csL[e * 128 + l]), sc1 = dtL[e * 128 + l + 1] * __expf(cl - csL[e * 128 + l + 1]);
#pragma unroll
                for (int e2 = 0; e2 < 8; ++e2) *(LAS unsigned*)(xT + (p8 + e2) * 136 + l) = cvt_pk_bf16(siluf_(v[e2]) * sc, siluf_(v1[e2]) * sc1);
            }
            __syncthreads();
            f32x4 acc[4];
#pragma unroll
            for (int pt = 0; pt < 4; ++pt) acc[pt] = (f32x4){0.f, 0.f, 0.f, 0.f};
#pragma unroll
            for (int kb = 0; kb < 4; ++kb) {
                const bf16x8 bfr = ldfrag(Bt_s, 136, 16 * w + fr, kb, q);
#pragma unroll
                for (int pt = 0; pt < 4; ++pt) { const bf16x8 afr = ldfrag(xT, 136, 16 * pt + fr, kb, q); acc[pt] = __builtin_amdgcn_mfma_f32_16x16x32_bf16(bfr, afr, acc[pt], 0, 0, 0); }
            }
#pragma unroll
            for (int pt = 0; pt < 4; ++pt) {
#ifdef DBG_S1_CONST
                acc[pt] = (f32x4){1.f, 2.f, 3.f, (float)(h + pt)};
#endif
                u32x2 wv; wv.x = cvt_pk_bf16(acc[pt][0], acc[pt][1]); wv.y = cvt_pk_bf16(acc[pt][2], acc[pt][3]);
                *(u32x2*)(ST + ((((size_t)b * 32 + c) * 32 + h) * 64 + 16 * pt + fr) * 128 + 16 * w + 4 * q) = wv;
            }
            __syncthreads();
        }
    }
}

__device__ void ph_ssd_carry(const Params& p) {
    bf16_t* ST = (bf16_t*)(p.ws + WS_ST); const float* TOT = (const float*)(p.ws + WS_TOT);
    for (int idx = obid() * 512 + otid(); idx < 8 * 32 * 64 * 16; idx += gridDim.x * 512) {
        const int n8 = idx & 15, pp = (idx >> 4) & 63, h = (idx >> 10) & 31, b = idx >> 15;
        float s[8];
#pragma unroll
        for (int i = 0; i < 8; ++i) s[i] = 0.f;
        for (int c = 0; c < 32; ++c) {
            bf16_t* ptr = ST + ((((size_t)b * 32 + c) * 32 + h) * 64 + pp) * 128 + n8 * 8;
            const u32x4 v = *(const u32x4*)ptr;
            const float dec = __expf(TOT[(b * 32 + c) * 32 + h]);
            u32x4 wv; wv.x = cvt_pk_bf16(s[0], s[1]); wv.y = cvt_pk_bf16(s[2], s[3]); wv.z = cvt_pk_bf16(s[4], s[5]); wv.w = cvt_pk_bf16(s[6], s[7]);
            *(u32x4*)ptr = wv;
            s[0] = s[0] * dec + bf_lo(v.x); s[1] = s[1] * dec + bf_hi(v.x); s[2] = s[2] * dec + bf_lo(v.y); s[3] = s[3] * dec + bf_hi(v.y);
            s[4] = s[4] * dec + bf_lo(v.z); s[5] = s[5] * dec + bf_hi(v.z); s[6] = s[6] * dec + bf_lo(v.w); s[7] = s[7] * dec + bf_hi(v.w);
        }
    }
}

__device__ void ph_ssd_out(const Params& p, int j, LAS unsigned char* lds) {
    LAS bf16_t* RA = (LAS bf16_t*)lds;
    LAS bf16_t* Cs = (LAS bf16_t*)(lds + 34816);
    LAS bf16_t* xdtT = (LAS bf16_t*)(lds + 69632);
    LAS bf16_t* Ent = (LAS bf16_t*)(lds + 87040);
    LAS bf16_t* xsN = (LAS bf16_t*)(lds + 104448);
    LAS float* csL = (LAS float*)(lds + 122880);
    LAS float* dtL = (LAS float*)(lds + 126976);
    bf16_t* PROJ = (bf16_t*)(p.ws + WS_PROJ); const float* DTb = (const float*)(p.ws + WS_DT);
    const bf16_t* ST = (const bf16_t*)(p.ws + WS_ST);
    const float* conv_w = p.in[6] + (size_t)j * 4 * 3072; const float* conv_b = p.in[7] + (size_t)j * 3072;
    const float* dt_bias = p.in[8] + j * 32; const float* a_log = p.in[9] + j * 32; const float* dskip = p.in[10] + j * 32; const float* nw = p.in[11] + (size_t)j * 2048;
    const int tid = otid(), w = tid >> 6, lane = tid & 63, fr = lane & 15, q = lane >> 4;
    for (int item = obid(); item < 1024; item += gridDim.x) {
        const int b = item >> 7, c = (item >> 2) & 31, g = item & 3;
        const size_t t0 = (size_t)b * 4096 + c * 128;
        ssd_cs(DTb, dt_bias, a_log, t0, g, csL, dtL, nullptr);
        for (int idx = tid; idx < 128 * 32; idx += 512) {
            const int which = idx >> 11, l = (idx >> 4) & 127, n8 = (idx & 15) * 8, cc = 2048 + which * 512 + g * 128 + n8;
            float v[8]; conv8<4>(PROJ, 5120, t0 + l, c * 128 + l, 2048 + cc, conv_w, 3072, conv_b, cc, v);
            u32x4 wv; wv.x = cvt_pk_bf16(siluf_(v[0]), siluf_(v[1])); wv.y = cvt_pk_bf16(siluf_(v[2]), siluf_(v[3])); wv.z = cvt_pk_bf16(siluf_(v[4]), siluf_(v[5])); wv.w = cvt_pk_bf16(siluf_(v[6]), siluf_(v[7]));
            *(LAS u32x4*)((which ? Cs : RA) + l * 136 + n8) = wv;
        }
        __syncthreads();
        const int l = 16 * w + fr;
        f32x4 cb[8];
#pragma unroll
        for (int st = 0; st < 8; ++st) cb[st] = (f32x4){0.f, 0.f, 0.f, 0.f};
#pragma unroll
        for (int kb = 0; kb < 4; ++kb) {
            const bf16x8 cf = ldfrag(Cs, 136, l, kb, q);
#pragma unroll
            for (int st = 0; st < 8; ++st) { const bf16x8 bfr = ldfrag(RA, 136, 16 * st + fr, kb, q); cb[st] = __builtin_amdgcn_mfma_f32_16x16x32_bf16(bfr, cf, cb[st], 0, 0, 0); }
        }
        __syncthreads();
        float ss = 0.f;
        for (int e = 0; e < 8; ++e) {
            const int h = g * 8 + e;
            {
                const int ll = (tid >> 3) * 2, p8 = (tid & 7) * 8, cc = h * 64 + p8;
                float v[8], v1[8]; conv8<4>(PROJ, 5120, t0 + ll, c * 128 + ll, 2048 + cc, conv_w, 3072, conv_b, cc, v);
                conv8<4>(PROJ, 5120, t0 + ll + 1, c * 128 + ll + 1, 2048 + cc, conv_w, 3072, conv_b, cc, v1);
                const float dtv = dtL[e * 128 + ll], dtv1 = dtL[e * 128 + ll + 1];
#pragma unroll
                for (int e2 = 0; e2 < 8; ++e2) { v[e2] = siluf_(v[e2]); v1[e2] = siluf_(v1[e2]); *(LAS unsigned*)(xdtT + (p8 + e2) * 136 + ll) = cvt_pk_bf16(v[e2] * dtv, v1[e2] * dtv1); }
                u32x4 wv; wv.x = cvt_pk_bf16(v[0], v[1]); wv.y = cvt_pk_bf16(v[2], v[3]); wv.z = cvt_pk_bf16(v[4], v[5]); wv.w = cvt_pk_bf16(v[6], v[7]);
                *(LAS u32x4*)(xsN + ll * 72 + p8) = wv;
                wv.x = cvt_pk_bf16(v1[0], v1[1]); wv.y = cvt_pk_bf16(v1[2], v1[3]); wv.z = cvt_pk_bf16(v1[4], v1[5]); wv.w = cvt_pk_bf16(v1[6], v1[7]);
                *(LAS u32x4*)(xsN + (ll + 1) * 72 + p8) = wv;
            }
            for (int idx = tid; idx < 64 * 16; idx += 512) {
                const int pp = idx >> 4, n8 = (idx & 15) * 8;
                *(LAS u32x4*)(Ent + pp * 136 + n8) = *(const u32x4*)(ST + ((((size_t)b * 32 + c) * 32 + h) * 64 + pp) * 128 + n8);
            }
            const float csl = csL[e * 128 + l];
#pragma unroll
            for (int st = 0; st < 8; ++st) {
                float sv[4];
#pragma unroll
                for (int jj = 0; jj < 4; ++jj) { const int s = 16 * st + 4 * q + jj; sv[jj] = (s <= l) ? cb[st][jj] * __expf(fminf(csl - csL[e * 128 + s], 0.f)) : 0.f; }
                u32x2 wv; wv.x = cvt_pk_bf16(sv[0], sv[1]); wv.y = cvt_pk_bf16(sv[2], sv[3]);
                *(LAS u32x2*)(RA + l * 136 + 16 * st + 4 * q) = wv;
            }
            __syncthreads();
            f32x4 yd[4], yo[4];
#pragma unroll
            for (int pt = 0; pt < 4; ++pt) { yd[pt] = (f32x4){0.f, 0.f, 0.f, 0.f}; yo[pt] = (f32x4){0.f, 0.f, 0.f, 0.f}; }
#pragma unroll
            for (int kb = 0; kb < 4; ++kb) {
                const bf16x8 sf = ldfrag(RA, 136, l, kb, q), cf = ldfrag(Cs, 136, l, kb, q);
#pragma unroll
                for (int pt = 0; pt < 4; ++pt) {
                    const bf16x8 xf = ldfrag(xdtT, 136, 16 * pt + fr, kb, q), ef = ldfrag(Ent, 136, 16 * pt + fr, kb, q);
                    yd[pt] = __builtin_amdgcn_mfma_f32_16x16x32_bf16(xf, sf, yd[pt], 0, 0, 0);
                    yo[pt] = __builtin_amdgcn_mfma_f32_16x16x32_bf16(ef, cf, yo[pt], 0, 0, 0);
                }
            }
            const float el = __expf(csl), Dh = dskip[h];
#pragma unroll
            for (int pt = 0; pt < 4; ++pt) {
                const u32x2 xs2 = *(const LAS u32x2*)(xsN + l * 72 + 16 * pt + 4 * q);
                bf16_t* zp = PROJ + (t0 + l) * 5120 + h * 64 + 16 * pt + 4 * q;
                const u32x2 z2 = *(const u32x2*)zp;
                const float y0 = yd[pt][0] + el * yo[pt][0] + Dh * bf_lo(xs2.x), y1 = yd[pt][1] + el * yo[pt][1] + Dh * bf_hi(xs2.x);
                const float y2 = yd[pt][2] + el * yo[pt][2] + Dh * bf_lo(xs2.y), y3 = yd[pt][3] + el * yo[pt][3] + Dh * bf_hi(xs2.y);
                const float g0 = y0 * siluf_(bf_lo(z2.x)), g1 = y1 * siluf_(bf_hi(z2.x)), g2 = y2 * siluf_(bf_lo(z2.y)), g3 = y3 * siluf_(bf_hi(z2.y));
                ss += (g0 * g0 + g1 * g1) + (g2 * g2 + g3 * g3);
                u32x2 wv; wv.x = cvt_pk_bf16(g0, g1); wv.y = cvt_pk_bf16(g2, g3);
                *(u32x2*)zp = wv;
            }
            __syncthreads();
        }
        ss += __shfl_xor(ss, 16); ss += __shfl_xor(ss, 32);
        const float rstd = rsqrtf(ss * (1.f / 512.f) + EPS);
        for (int e = 0; e < 8; ++e) {
            const int h = g * 8 + e;
#pragma unroll
            for (int pt = 0; pt < 4; ++pt) {
                const int ch = h * 64 + 16 * pt + 4 * q;
                bf16_t* zp = PROJ + (t0 + l) * 5120 + ch;
                const u32x2 g2 = *(const u32x2*)zp; const f32x4 wn = *(const f32x4*)(nw + ch);
                u32x2 wv; wv.x = cvt_pk_bf16(bf_lo(g2.x) * rstd * wn[0], bf_hi(g2.x) * rstd * wn[1]); wv.y = cvt_pk_bf16(bf_lo(g2.y) * rstd * wn[2], bf_hi(g2.y) * rstd * wn[3]);
                *(u32x2*)zp = wv;
            }
        }
    }
}

template <int PASS>
__device__ void ph_lru(const Params& p, int j, LAS unsigned char* lds) {
    LAS bf16_t* Xs = (LAS bf16_t*)lds;
    LAS float* Hs = (LAS float*)(lds + 34816);
    const bf16_t* PROJ = (const bf16_t*)(p.ws + WS_PROJ);
    bf16_t* HY = (bf16_t*)(p.ws + WS_PROJ + LRU_HY_OFF);
    const bf16_t* WG = (const bf16_t*)(p.ws + WS_WG);
    float* AGG = (float*)(p.ws + WS_AGG); const float* CAR = (const float*)(p.ws + WS_CAR);
    const float* conv_w = p.in[15] + (size_t)j * 4 * 1280; const float* conv_b = p.in[16] + (size_t)j * 1280;
    const float* b_gx = p.in[18] + (size_t)j * 1280; const float* b_ga = p.in[20] + (size_t)j * 1280; const float* lam = p.in[21] + (size_t)j * 1280;
    const int tid = otid(), w = tid >> 6, lane = tid & 63, fr = lane & 15, q = lane >> 4;
    for (int item = obid(); item < 2560; item += gridDim.x) {
        const int hh = item % 10, tt = (item / 10) & 31, b = item / 320;
        const size_t t0 = (size_t)b * 4096 + tt * 128;
        for (int idx = tid; idx < 128 * 16; idx += 512) {
            const int l = idx >> 4, c8 = (idx & 15) * 8, cc = hh * 128 + c8;
            float v[8]; conv8<4>(PROJ, 2560, t0 + l, tt * 128 + l, 1280 + cc, conv_w, 1280, conv_b, cc, v);
            u32x4 wv; wv.x = cvt_pk_bf16(v[0], v[1]); wv.y = cvt_pk_bf16(v[2], v[3]); wv.z = cvt_pk_bf16(v[4], v[5]); wv.w = cvt_pk_bf16(v[6], v[7]);
            *(LAS u32x4*)(Xs + l * 136 + c8) = wv;
        }
        __syncthreads();
        const bf16_t* wg = WG + (size_t)hh * 256 * 128;
        bf16x8 bx[4], ba[4];
#pragma unroll
        for (int kb = 0; kb < 4; ++kb) { bx[kb] = *(const bf16x8*)(wg + (16 * w + fr) * 128 + kb * 32 + q * 8); ba[kb] = *(const bf16x8*)(wg + (128 + 16 * w + fr) * 128 + kb * 32 + q * 8); }
        f32x4 ax[8], aa[8];
#pragma unroll
        for (int mt = 0; mt < 8; ++mt) { ax[mt] = (f32x4){0.f, 0.f, 0.f, 0.f}; aa[mt] = (f32x4){0.f, 0.f, 0.f, 0.f}; }
#pragma unroll
        for (int mt = 0; mt < 8; ++mt)
#pragma unroll
            for (int kb = 0; kb < 4; ++kb) {
                const bf16x8 af = ldfrag(Xs, 136, 16 * mt + fr, kb, q);
                ax[mt] = __builtin_amdgcn_mfma_f32_16x16x32_bf16(af, bx[kb], ax[mt], 0, 0, 0);
                aa[mt] = __builtin_amdgcn_mfma_f32_16x16x32_bf16(af, ba[kb], aa[mt], 0, 0, 0);
            }
        const int ch = hh * 128 + 16 * w + fr;
        const float bgx = b_gx[ch], bga = b_ga[ch];
        const float ls8 = -8.f * log1pf(expf(-lam[ch])) * 1.44269504f;
#pragma unroll
        for (int mt = 0; mt < 8; ++mt)
#pragma unroll
            for (int jj = 0; jj < 4; ++jj) {
                const int l = 16 * mt + 4 * q + jj;
                const float xv = bf2f(Xs[l * 136 + 16 * w + fr]);
                const float gx = sigmoidf_(ax[mt][jj] + bgx), ga = sigmoidf_(aa[mt][jj] + bga);
                const float a = __builtin_amdgcn_exp2f(ls8 * ga);
                const float mult = sqrtf(fmaxf(1.f - a * a, 0.f));
                aa[mt][jj] = a; ax[mt][jj] = mult * gx * xv;
            }
        float hin = 0.f, Atot = 1.f, Btot = 0.f;
        if (PASS == 1) hin = CAR[((size_t)b * 32 + tt) * 1280 + ch];
#pragma unroll
        for (int mt = 0; mt < 8; ++mt) {
            float IA = 1.f, IB = 0.f;
#pragma unroll
            for (int jj = 0; jj < 4; ++jj) { IB = aa[mt][jj] * IB + ax[mt][jj]; IA = aa[mt][jj] * IA; }
            float tA = __shfl_up(IA, 16), tB = __shfl_up(IB, 16);
            if (q >= 1) { IB = IA * tB + IB; IA = IA * tA; }
            tA = __shfl_up(IA, 32); tB = __shfl_up(IB, 32);
            if (q >= 2) { IB = IA * tB + IB; IA = IA * tA; }
            float EA = __shfl_up(IA, 16), EB = __shfl_up(IB, 16);
            if (q == 0) { EA = 1.f; EB = 0.f; }
            const float TA = __shfl(IA, fr + 48), TB = __shfl(IB, fr + 48);
            if (PASS == 1) {
                float hv = EA * hin + EB;
#pragma unroll
                for (int jj = 0; jj < 4; ++jj) { hv = aa[mt][jj] * hv + ax[mt][jj]; ax[mt][jj] = hv; }
                hin = TA * hin + TB;
            } else { Btot = TA * Btot + TB; Atot = TA * Atot; }
        }
        if (PASS == 0) {
            if (q == 0) { AGG[(((size_t)b * 32 + tt) * 1280 + ch) * 2] = Atot; AGG[(((size_t)b * 32 + tt) * 1280 + ch) * 2 + 1] = Btot; }
            __syncthreads();
        } else {
#pragma unroll
            for (int mt = 0; mt < 8; ++mt)
#pragma unroll
                for (int jj = 0; jj < 4; ++jj) Hs[(16 * mt + 4 * q + jj) * 132 + 16 * w + fr] = ax[mt][jj];
            __syncthreads();
            for (int idx = tid; idx < 128 * 16; idx += 512) {
                const int l = idx >> 4, c8 = (idx & 15) * 8;
                const u32x4 y = *(const u32x4*)(PROJ + (t0 + l) * 2560 + hh * 128 + c8);
                const f32x4 h0 = *(const LAS f32x4*)(Hs + l * 132 + c8), h1 = *(const LAS f32x4*)(Hs + l * 132 + c8 + 4);
                u32x4 wv;
                wv.x = cvt_pk_bf16(h0[0] * geluf_(bf_lo(y.x)), h0[1] * geluf_(bf_hi(y.x))); wv.y = cvt_pk_bf16(h0[2] * geluf_(bf_lo(y.y)), h0[3] * geluf_(bf_hi(y.y)));
                wv.z = cvt_pk_bf16(h1[0] * geluf_(bf_lo(y.z)), h1[1] * geluf_(bf_hi(y.z))); wv.w = cvt_pk_bf16(h1[2] * geluf_(bf_lo(y.w)), h1[3] * geluf_(bf_hi(y.w)));
                *(u32x4*)(HY + (t0 + l) * 1280 + hh * 128 + c8) = wv;
            }
            __syncthreads();
        }
    }
}

__device__ void ph_lru_carry(const Params& p) {
    const float* AGG = (const float*)(p.ws + WS_AGG); float* CAR = (float*)(p.ws + WS_CAR);
    for (int idx = obid() * 512 + otid(); idx < 8 * 1280; idx += gridDim.x * 512) {
        const int b = idx / 1280, ch = idx % 1280;
        float carry = 0.f;
        for (int tt = 0; tt < 32; ++tt) {
            const size_t o = ((size_t)b * 32 + tt) * 1280 + ch;
            CAR[o] = carry;
            carry = AGG[o * 2] * carry + AGG[o * 2 + 1];
        }
    }
}

__global__ void __launch_bounds__(512, 2) mega(Params p) {
    extern __shared__ __attribute__((aligned(16))) unsigned char smem[];
    LAS unsigned char* lds = (LAS unsigned char*)smem;
    unsigned char* ws = p.ws;
    bf16_t* H = (bf16_t*)(ws + WS_H); bf16_t* Mb = (bf16_t*)(ws + WS_M); bf16_t* PROJ = (bf16_t*)(ws + WS_PROJ);
    float* RSM = (float*)(ws + WS_RSM); float* RSF = (float*)(ws + WS_RSF);
    for (int ph = p.ph_lo; ph < p.ph_hi; ++ph) {
        if (ph == 0) {
            cvt_mixer_weights(p, 0, lds); cvt_ffn_weights(p, 0, lds);
            ph_resnorm(p.in[0], nullptr, nullptr, nullptr, nullptr, p.in[1], H);
        } else {
            const int layer = (ph - 1) / 9, k = (ph - 1) % 9, j = layer >> 1; const bool ssd = (layer & 1) == 0;
            Gemm g{}; EpiStore E{}; bool gs = false;
            if (k == 0) {
                gs = true;
                if (ssd) { g = Gemm{H, (const bf16_t*)(ws + WS_WIN), 1024, 1024, 1024, 128, 21, 256}; E = EpiStore{PROJ, 5120, nullptr, 20, (float*)(ws + WS_DT), nullptr}; }
                else { g = Gemm{H, (const bf16_t*)(ws + WS_WIN), 1024, 1024, 1024, 128, 10, 256}; E = EpiStore{PROJ, 2560, p.in[14] + (size_t)j * 2560, -1, nullptr, nullptr}; }
            } else if (k == 1) { if (ssd) ph_ssd_states(p, j, lds); else ph_lru<0>(p, j, lds); }
            else if (k == 2) { if (ssd) ph_ssd_carry(p); else ph_lru_carry(p); }
            else if (k == 3) { if (ssd) ph_ssd_out(p, j, lds); else ph_lru<1>(p, j, lds); }
            else if (k == 4) {
                gs = true;
                if (ssd) { g = Gemm{PROJ, (const bf16_t*)(ws + WS_WOUT), 2048, 5120, 2048, 128, 4, 256}; E = EpiStore{Mb, 1024, nullptr, -1, nullptr, RSM}; }
                else { g = Gemm{(const bf16_t*)(ws + WS_PROJ + LRU_HY_OFF), (const bf16_t*)(ws + WS_WOUT), 1280, 1280, 1280, 128, 4, 256}; E = EpiStore{Mb, 1024, p.in[23] + (size_t)j * 1024, -1, nullptr, RSM}; }
            } else if (k == 5) {
                ph_resnorm(layer == 0 ? p.in[0] : p.out, p.out, Mb, RSM, p.in[2] + layer * 1024, p.in[3] + layer * 1024, H);
                if (layer < 3) cvt_mixer_weights(p, layer + 1, lds);
            } else if (k == 6) {
                Gemm g2{H - 2 * 1024, (const bf16_t*)(ws + WS_WUP), 1024, 1024, 1024, 130, 32, 254};
                EpiFfnUp E2{PROJ, p.in[25] + (size_t)layer * 3 * 8192, p.in[26] + (size_t)layer * 8192}; gemm_phase(lds, g2, E2);
            } else if (k == 7) {
                gs = true;
                g = Gemm{PROJ, (const bf16_t*)(ws + WS_WDN), 4096, 4096, 4096, 128, 4, 256}; E = EpiStore{Mb, 1024, nullptr, -1, nullptr, RSF};
            } else {
                ph_resnorm(p.out, p.out, Mb, RSF, p.in[4] + layer * 1024, layer < 3 ? p.in[1] + (layer + 1) * 1024 : nullptr, H);
                if (layer < 3) cvt_ffn_weights(p, layer + 1, lds);
            }
            if (gs) gemm_phase(lds, g, E);
        }
        if (ph + 1 < p.ph_hi) cg::this_grid().sync();
    }
}


#ifdef DBG_STOP
__global__ void dbg_dump(Params p, int k) {
    const unsigned char* ws = p.ws;
    const bf16_t* H = (const bf16_t*)(ws + WS_H); const bf16_t* Mb = (const bf16_t*)(ws + WS_M); const bf16_t* PROJ = (const bf16_t*)(ws + WS_PROJ);
    const float* DT = (const float*)(ws + WS_DT); const float* RS = (const float*)(ws + WS_RSM); const float* TOT = (const float*)(ws + WS_TOT);
    const float* AGG = (const float*)(ws + WS_AGG);
    for (size_t i = (size_t)blockIdx.x * blockDim.x + threadIdx.x; i < (size_t)T * 1024; i += (size_t)gridDim.x * blockDim.x) {
        float v = bf2f(H[i]) + bf2f(Mb[i]) + DT[i % ((size_t)T * 32)] + RS[i % ((size_t)T * 32)] + TOT[i % 8192] + AGG[i % (8 * 32 * 1280 * 3)];
        for (int r = 0; r < 5; ++r) v += bf2f(PROJ[i * 5 + r]);
        if (k >= 7) v += p.out[i];
        p.out[i] = v;
    }
}
#endif
extern "C" void kernel_launch(void* const* d_in, const int* in_sizes, int n_in, void* d_out, int out_size, void* d_ws, size_t ws_size, hipStream_t stream) {
    static int grid = 0;
    if (grid == 0) {
        if (n_in != 28 || out_size != T * DM || ws_size < WS_END) { fprintf(stderr, "kernel_launch: unexpected shapes (n_in %d out %d ws %zu need %zu)\n", n_in, out_size, ws_size, (size_t)WS_END); grid = -1; return; }
        int dev = 0, cus = 0, per_cu = 0;
        hipGetDevice(&dev); hipDeviceGetAttribute(&cus, hipDeviceAttributeMultiprocessorCount, dev);
        if (hipFuncSetAttribute((const void*)mega, hipFuncAttributeMaxDynamicSharedMemorySize, LDS_BYTES) != hipSuccess) { fprintf(stderr, "hipFuncSetAttribute failed\n"); grid = -1; return; }
        hipOccupancyMaxActiveBlocksPerMultiprocessor(&per_cu, (const void*)mega, 512, LDS_BYTES);
        (void)hipGetLastError();
        if (per_cu < 1) per_cu = 1;
        grid = cus * 1;
    }
    if (grid < 0) return;
    Params p{};
    for (int i = 0; i < 28; ++i) p.in[i] = (const float*)d_in[i];
    p.out = (float*)d_out; p.ws = (unsigned char*)d_ws;
#if ONE_LAUNCH
    p.ph_lo = 0; p.ph_hi = NPHASE;
    void* args[] = {&p};
    hipError_t e = hipLaunchCooperativeKernel((void*)mega, dim3(grid), dim3(512), args, LDS_BYTES, stream);
    if (e != hipSuccess) fprintf(stderr, "cooperative launch failed: %s (grid %d)\n", hipGetErrorString(e), grid);
#else
#ifdef DBG_STOP
    for (int ph = 0; ph < DBG_STOP; ++ph) {
        p.ph_lo = ph; p.ph_hi = ph + 1;
        hipLaunchKernelGGL(mega, dim3(grid), dim3(512), LDS_BYTES, stream, p);
    }
    p.ph_lo = 0; p.ph_hi = 0;
    hipLaunchKernelGGL(dbg_dump, dim3(2048), dim3(256), 0, stream, p, DBG_STOP);
#else
    for (int ph = 0; ph < NPHASE; ++ph) {
        p.ph_lo = ph; p.ph_hi = ph + 1;
        hipLaunchKernelGGL(mega, dim3(grid), dim3(512), LDS_BYTES, stream, p);
    }
#endif
#endif
}
```
